# Optimizing an MI355X kernel written in HIP

```python
import jax, jax.numpy as jnp
from jax import lax
import numpy as np

D_MODEL = 1024
BATCH = 1
SEQ = 16384
DEPTH = 2
DEC_BATCH = 32
DEC_SEQ = 32
PAST_LEN = 2048

CHUNK = 64
N_A = DEPTH // 2
N_B = DEPTH - N_A
HEAD_DIM = 64
GM_CHUNK = 128
GM_GROUPS = 4
GM_W = 3 * D_MODEL // 4
GM_GW = GM_W // GM_GROUPS
MEM_LEN = 256
MEM_HEADS = 4
MEM_W = MEM_HEADS * HEAD_DIM
B_HEADS = GM_W // HEAD_DIM
B_W = B_HEADS * HEAD_DIM
LOOKBACK_CHUNKS = 8
BAND_PAST = LOOKBACK_CHUNKS * CHUNK
BAND = BAND_PAST + CHUNK
REL_CLIP = 128
D_FF = 4 * D_MODEL
EPS = 1e-6

kernel_name = "yoco_gmlp_chunkband_stream_step"


def _rms_norm(x, g):
    xf = x.astype(jnp.float32)
    y = xf * lax.rsqrt(jnp.mean(xf * xf, axis=-1, keepdims=True) + EPS)
    return (y * g.astype(jnp.float32)).astype(x.dtype)


def _group_layer_norm(x, g, b):
    shp = x.shape
    xf = x.astype(jnp.float32).reshape(shp[:-1] + (GM_GROUPS, GM_GW))
    mu = jnp.mean(xf, axis=-1, keepdims=True)
    var = jnp.mean(jnp.square(xf - mu), axis=-1, keepdims=True)
    y = ((xf - mu) * lax.rsqrt(var + EPS)).reshape(shp)
    return (y * g.astype(jnp.float32) + b.astype(jnp.float32)).astype(x.dtype)


def _ffn(x, g_pre, g_post, w1, w2):
    h = jnp.square(jax.nn.relu(_rms_norm(x, g_pre) @ w1)) @ w2
    return x + _rms_norm(h, g_post)


def _mem_kv(mem, g, w):
    b, m, _ = mem.shape
    h = _rms_norm(mem, g) @ w
    k = h[..., :MEM_W].reshape(b, m, MEM_HEADS, HEAD_DIM)
    v = h[..., MEM_W:].reshape(b, m, MEM_HEADS, HEAD_DIM)
    return k, v


def _shared_kv(x, g, w):
    b, s, _ = x.shape
    h = _rms_norm(x, g) @ w
    k = h[..., :B_W].reshape(b, s, B_HEADS, HEAD_DIM)
    v = h[..., B_W:].reshape(b, s, B_HEADS, HEAD_DIM)
    return k, v


def _softmax_attend(q, k, v, bias=None, valid=None):
    s = jnp.einsum('bqhd,bkhd->bhqk', q, k).astype(jnp.float32) * (HEAD_DIM ** -0.5)
    if bias is not None:
        s = s + bias.astype(jnp.float32)
    if valid is not None:
        s = jnp.where(valid, s, -jnp.inf)
    p = jax.nn.softmax(s, axis=-1).astype(v.dtype)
    return jnp.einsum('bhqk,bkhd->bqhd', p, v)


def _rel_bias(rel_bias, n_q, n_k, n_past):
    rel = n_past + jnp.arange(n_q)[:, None] - jnp.arange(n_k)[None, :]
    idx = jnp.clip(rel, -REL_CLIP, REL_CLIP) + REL_CLIP
    return rel_bias[:, idx]


def _band_prompt(q, k, v, rel_bias):
    b, s, h, d = q.shape
    n = s // CHUNK
    pad = ((0, 0), (BAND_PAST, 0), (0, 0), (0, 0))
    kp, vp = jnp.pad(k, pad), jnp.pad(v, pad)
    bias = _rel_bias(rel_bias, CHUNK, BAND, BAND_PAST)
    j = jnp.arange(BAND)

    def one_chunk(c):
        start = c * CHUNK
        qc = lax.dynamic_slice_in_dim(q, start, CHUNK, axis=1)
        kc = lax.dynamic_slice_in_dim(kp, start, BAND, axis=1)
        vc = lax.dynamic_slice_in_dim(vp, start, BAND, axis=1)
        valid = (start - BAND_PAST + j >= 0)[None, :]
        return _softmax_attend(qc, kc, vc, bias, valid)

    out = lax.map(one_chunk, jnp.arange(n))
    return jnp.moveaxis(out, 0, 1).reshape(b, s, h * d)


def _band_sample(q, k_cache, v_cache, k_new, v_new, rel_bias):
    b, t, h, d = q.shape
    p = k_cache.shape[1]
    k = jnp.concatenate([k_cache, k_new], axis=1)
    v = jnp.concatenate([v_cache, v_new], axis=1)
    bias = _rel_bias(rel_bias, t, p + t, p)
    return _softmax_attend(q, k, v, bias).reshape(b, t, h * d)


def _causal_spatial(w_s):
    mask = jnp.tril(jnp.ones((GM_CHUNK, GM_CHUNK), dtype=bool))
    return jnp.where(mask, w_s, jnp.zeros((), w_s.dtype))


def _gmlp_prompt(u, v, w_s, b_s):
    b, s, _ = v.shape
    n = s // GM_CHUNK
    vg = v.reshape(b, n, GM_CHUNK, GM_GROUPS, GM_GW)
    mixed = jnp.einsum('gts,bnsgc->bntgc', _causal_spatial(w_s), vg) + b_s.T[:, :, None]
    return u * mixed.reshape(b, s, GM_W)


def _gmlp_sample(u, v, w_s, b_s):
    b, t, _ = v.shape
    vg = v.reshape(b, t, GM_GROUPS, GM_GW)
    mixed = jnp.einsum('gts,bsgc->btgc', _causal_spatial(w_s)[:, :t, :t], vg) + b_s[:, :t].T[:, :, None]
    return u * mixed.reshape(b, t, GM_W)


def _mixer_a(x, mem_k, mem_v, spatial, g_pre, g_post, w_in, g_ln, b_ln, w_s, b_s, w_out):
    b, s, _ = x.shape
    z = _rms_norm(x, g_pre) @ w_in
    zg = jax.nn.gelu(z[..., :2 * GM_W])
    u = zg[..., :GM_W]
    v = _group_layer_norm(zg[..., GM_W:], g_ln, b_ln)
    gm = spatial(u, v, w_s, b_s)
    qm = z[..., 2 * GM_W:].reshape(b, s, MEM_HEADS, HEAD_DIM)
    mo = _softmax_attend(qm, mem_k, mem_v).reshape(b, s, MEM_W)
    y = jnp.concatenate([gm, mo], axis=-1) @ w_out
    return x + _rms_norm(y, g_post), v


def _mixer_b(x, mem_k, mem_v, band, g_pre, g_post, w_in, rel_bias, w_out):
    b, s, _ = x.shape
    z = _rms_norm(x, g_pre) @ w_in
    q = z[..., :B_W].reshape(b, s, B_HEADS, HEAD_DIM)
    qm = z[..., B_W:].reshape(b, s, MEM_HEADS, HEAD_DIM)
    mo = _softmax_attend(qm, mem_k, mem_v).reshape(b, s, MEM_W)
    y = jnp.concatenate([band(q, rel_bias), mo], axis=-1) @ w_out
    return x + _rms_norm(y, g_post)


def setup_inputs(seed: int = 0) -> dict:
    key = jax.random.key(seed)
    ks = jax.random.split(key, 26)
    f32 = jnp.float32

    def nrm(k, shape, scale=1.0):
        return jax.random.normal(k, shape, f32) * scale

    def gain(k, shape):
        return 1.0 + 0.05 * jax.random.normal(k, shape, f32)

    n_keep = min(BAND_PAST, PAST_LEN)
    return {
        "x_prompt": nrm(ks[0], (BATCH, SEQ, D_MODEL)),
        "x_sample": nrm(ks[1], (DEC_BATCH, DEC_SEQ, D_MODEL)),
        "cache_mem_k": nrm(ks[2], (DEPTH, DEC_BATCH, MEM_LEN, MEM_HEADS, HEAD_DIM)),
        "cache_mem_v": nrm(ks[3], (DEPTH, DEC_BATCH, MEM_LEN, MEM_HEADS, HEAD_DIM)),
        "cache_band_k": nrm(ks[4], (DEC_BATCH, n_keep, B_HEADS, HEAD_DIM)),
        "cache_band_v": nrm(ks[5], (DEC_BATCH, n_keep, B_HEADS, HEAD_DIM)),
        "mem_prompt": nrm(ks[6], (BATCH, MEM_LEN, D_MODEL)),
        "g_mix_pre": gain(ks[7], (DEPTH, D_MODEL)),
        "g_mix_post": gain(ks[8], (DEPTH, D_MODEL)),
        "g_ffn_pre": gain(ks[9], (DEPTH, D_MODEL)),
        "g_ffn_post": gain(ks[10], (DEPTH, D_MODEL)),
        "g_mem": gain(ks[11], (DEPTH, D_MODEL)),
        "w_mem_kv": nrm(ks[12], (DEPTH, D_MODEL, 2 * MEM_W), D_MODEL ** -0.5),
        "w_in_a": nrm(ks[13], (N_A, D_MODEL, 2 * GM_W + MEM_W), D_MODEL ** -0.5),
        "g_gm_ln": gain(ks[14], (N_A, GM_W)),
        "b_gm_ln": nrm(ks[15], (N_A, GM_W), 0.02),
        "w_spatial": nrm(ks[16], (N_A, GM_GROUPS, GM_CHUNK, GM_CHUNK), GM_CHUNK ** -0.5),
        "b_spatial": gain(ks[17], (N_A, GM_GROUPS, GM_CHUNK)),
        "w_out_a": nrm(ks[18], (N_A, GM_W + MEM_W, D_MODEL), (GM_W + MEM_W) ** -0.5),
        "g_kv": gain(ks[19], (D_MODEL,)),
        "w_kv": nrm(ks[20], (D_MODEL, 2 * B_W), D_MODEL ** -0.5),
        "w_in_b": nrm(ks[21], (N_B, D_MODEL, B_W + MEM_W), D_MODEL ** -0.5),
        "rel_bias": nrm(ks[22], (N_B, B_HEADS, 2 * REL_CLIP + 1), 0.5),
        "w_out_b": nrm(ks[23], (N_B, B_W + MEM_W, D_MODEL), (B_W + MEM_W) ** -0.5),
        "w_ff1": nrm(ks[24], (DEPTH, D_MODEL, D_FF), D_MODEL ** -0.5),
        "w_ff2": nrm(ks[25], (DEPTH, D_FF, D_MODEL), D_FF ** -0.5),
    }


def reference(x_prompt, x_sample, cache_mem_k, cache_mem_v, cache_band_k, cache_band_v, mem_prompt,
              g_mix_pre, g_mix_post, g_ffn_pre, g_ffn_post, g_mem, w_mem_kv,
              w_in_a, g_gm_ln, b_gm_ln, w_spatial, b_spatial, w_out_a,
              g_kv, w_kv, w_in_b, rel_bias, w_out_b, w_ff1, w_ff2):
    x = x_prompt
    mem_k_p, mem_v_p = [], []
    for l in range(DEPTH):
        mk, mv = _mem_kv(mem_prompt, g_mem[l], w_mem_kv[l])
        mem_k_p.append(mk)
        mem_v_p.append(mv)
        if l < N_A:
            x, _ = _mixer_a(x, mk, mv, _gmlp_prompt, g_mix_pre[l], g_mix_post[l], w_in_a[l],
                            g_gm_ln[l], b_gm_ln[l], w_spatial[l], b_spatial[l], w_out_a[l])
        else:
            if l == N_A:
                k_sh, v_sh = _shared_kv(x, g_kv, w_kv)
                band_p = lambda q, rb: _band_prompt(q, k_sh, v_sh, rb)
            i = l - N_A
            x = _mixer_b(x, mk, mv, band_p, g_mix_pre[l], g_mix_post[l], w_in_b[i], rel_bias[i], w_out_b[i])
        x = _ffn(x, g_ffn_pre[l], g_ffn_post[l], w_ff1[l], w_ff2[l])
    y_prompt = x
    n_keep = min(BAND_PAST, x_prompt.shape[1])
    band_k_prompt = k_sh[:, -n_keep:]
    band_v_prompt = v_sh[:, -n_keep:]

    x = x_sample
    gm_v = []
    for l in range(DEPTH):
        mk, mv = cache_mem_k[l], cache_mem_v[l]
        if l < N_A:
            x, v_rows = _mixer_a(x, mk, mv, _gmlp_sample, g_mix_pre[l], g_mix_post[l], w_in_a[l],
                                 g_gm_ln[l], b_gm_ln[l], w_spatial[l], b_spatial[l], w_out_a[l])
            gm_v.append(v_rows)
        else:
            if l == N_A:
                k_new, v_new = _shared_kv(x, g_kv, w_kv)
                band_s = lambda q, rb: _band_sample(q, cache_band_k, cache_band_v, k_new, v_new, rb)
            i = l - N_A
            x = _mixer_b(x, mk, mv, band_s, g_mix_pre[l], g_mix_post[l], w_in_b[i], rel_bias[i], w_out_b[i])
        x = _ffn(x, g_ffn_pre[l], g_ffn_post[l], w_ff1[l], w_ff2[l])
    y_sample = x

    return (y_prompt, y_sample, jnp.stack(mem_k_p), jnp.stack(mem_v_p), band_k_prompt, band_v_prompt,
            jnp.stack(gm_v), k_new, v_new)
```

```cpp
#include <hip/hip_runtime.h>
#include <cstdio>
#include <cstdint>

#ifndef MK_ONE_LAUNCH
#define MK_ONE_LAUNCH 0
#endif
#ifndef PHMASK
#define PHMASK 0xffff
#endif
#define PHON(k) ((PHMASK >> (k)) & 1)

namespace pg8 {
#define PG8_LAS __attribute__((address_space(3)))
typedef unsigned short bf16_t;
typedef short bf16x8 __attribute__((ext_vector_type(8)));
typedef float f32x4 __attribute__((ext_vector_type(4)));
typedef unsigned u32x4 __attribute__((ext_vector_type(4)));
constexpr int BM = 256, BK = 64, HALF = 128, HTB = HALF * BK * 2, STAGE_BYTES = 8 * HTB, NXCD = 8, WGM = 8;

__host__ __device__ __forceinline__ int lds_byte(int r, int c) { const int st = (r >> 4) * 2 + (c >> 5), rr = r & 15, cc = c & 31, ob = rr * 64 + cc * 2; return st * 1024 + (ob ^ (((ob >> 9) & 1) << 5)); }
__host__ __device__ __forceinline__ void stage_rc(int b, int& R, int& C) { const int st = b / 1024, sb = b % 1024, swz = sb ^ (((sb >> 9) & 1) << 5); R = (st >> 1) * 16 + swz / 64; C = (st & 1) * 32 + (swz % 64) / 2; }
__host__ __device__ __forceinline__ int perm32(int rho) { const int n = rho >> 4, i = rho & 15; return 8 * (i >> 2) + 4 * n + (i & 3); }

struct Unit { int pm, pn; };
struct Gemm { const bf16_t* A; const bf16_t* Bt; int M, N, K; };

struct StaticOrder {
    int nM, nN, nwg, G, c;
    __host__ __device__ void init(int M, int N, int G_, int c_) { nM = M / BM; nN = N / BM; nwg = nM * nN; G = G_; c = c_; }
    __host__ __device__ bool next(int i, Unit& u) const {
        const long L = (long)i * G + c; if (L >= nwg) return false;
        int wgid = (int)L; { const int q = nwg / NXCD, r = nwg % NXCD, xcd = wgid % NXCD, off = wgid / NXCD; wgid = (xcd < r ? xcd * (q + 1) : r * (q + 1) + (xcd - r) * q) + off; }
        const int nig = WGM * nN, gid = wgid / nig, fm = gid * WGM, gsz = (nM - fm) < WGM ? (nM - fm) : WGM;
        u.pm = fm + ((wgid % nig) % gsz); u.pn = (wgid % nig) / gsz; return true;
    }
    __device__ __forceinline__ void a_ready(const Unit&) const {}
    __device__ __forceinline__ void done(const Unit&) const {}
};
struct TailOrder {
    int G, c, n;
    __device__ __forceinline__ bool next(int i, Unit& u) const { if (i > 0 || c < G - n) return false; u.pm = 0; u.pn = c - (G - n); return true; }
    __device__ __forceinline__ void a_ready(const Unit&) const {}
    __device__ __forceinline__ void done(const Unit&) const {}
};

__device__ __forceinline__ unsigned cvt_pk_bf16(float lo, float hi) { unsigned r; asm volatile("v_cvt_pk_bf16_f32 %0, %1, %2" : "=v"(r) : "v"(lo), "v"(hi)); return r; }

__device__ __forceinline__ float gelu_tanh(float x) {
    const float u = x * (1.0f + 0.044715f * x * x) * (-2.302208198f);
    const float e = __builtin_amdgcn_exp2f(u);
    return x * __builtin_amdgcn_rcpf(1.0f + e);
}

constexpr size_t OUT_Y = 0, OUT_MK = 17825792, OUT_MV = OUT_MK + 131072, OUT_BKP = OUT_MV + 131072, OUT_BVP = OUT_BKP + 393216,
                 OUT_GV = OUT_BVP + 393216, OUT_BKS = OUT_GV + 786432, OUT_BVS = OUT_BKS + 786432, OUT_END = OUT_BVS + 786432;

template <int MODE> struct Epi {
    static constexpr bool PERM = true, AFTER_DRAIN = false;
    bf16_t* O; int ldc; float* out;
    __device__ __forceinline__ void operator()(const f32x4 (&acc)[2][2][4][2], const Unit& u, int wr, int wc, int fr, int fq) const {
        const int row0 = u.pm * BM + wr * 64 + fr, col0 = u.pn * BM + wc * 32 + 8 * fq;
#pragma unroll
        for (int ai = 0; ai < 2; ++ai)
#pragma unroll
            for (int m = 0; m < 4; ++m) { const int row = row0 + ai * HALF + m * 16;
#pragma unroll
                for (int bj = 0; bj < 2; ++bj) { const int col = col0 + bj * HALF; f32x4 v0 = acc[ai][bj][m][0], v1 = acc[ai][bj][m][1];
                    if (MODE == 1) { if (u.pn < 6) {
#pragma unroll
                        for (int e = 0; e < 4; ++e) { v0[e] = gelu_tanh(v0[e]); v1[e] = gelu_tanh(v1[e]); } } }
                    if (MODE == 2) {
#pragma unroll
                        for (int e = 0; e < 4; ++e) { const float a = v0[e] > 0.f ? v0[e] : 0.f, b = v1[e] > 0.f ? v1[e] : 0.f; v0[e] = a * a; v1[e] = b * b; } }
                    u32x4 w; w.x = cvt_pk_bf16(v0[0], v0[1]); w.y = cvt_pk_bf16(v0[2], v0[3]); w.z = cvt_pk_bf16(v1[0], v1[1]); w.w = cvt_pk_bf16(v1[2], v1[3]);
                    if (MODE == 4) {
                        const int l = u.pn >> 1, isv = u.pn & 1, c = col & 255;
                        *(u32x4*)(O + (size_t)(l * 256 + row) * 512 + isv * 256 + c) = w;
                        float* d = out + (isv ? OUT_MV : OUT_MK) + (size_t)(l * 256 + row) * 256 + c;
                        *(f32x4*)d = v0; *(f32x4*)(d + 4) = v1;
                    } else {
                        *(u32x4*)(O + (size_t)row * ldc + col) = w;
                    }
                    if (MODE == 3) { if (u.pn < 6 && u.pm >= 62) {
                        const bool isv = u.pn >= 3; const int c = col - (isv ? 768 : 0);
                        float* d = (u.pm >= 64) ? out + (isv ? OUT_BVS : OUT_BKS) + (size_t)(row - 16384) * 768 + c
                                                : out + (isv ? OUT_BVP : OUT_BKP) + (size_t)(row - 15872) * 768 + c;
                        *(f32x4*)d = v0; *(f32x4*)(d + 4) = v1; } }
                }
                __builtin_amdgcn_sched_barrier(0); }
    }
};

template <class Epi, class Sched, bool ALIGN_EPI = false, bool SP2 = false>
__device__ __forceinline__ void gemm_phase(PG8_LAS unsigned char* lds, const int tid, const Gemm g, const Sched& S, const Epi& E) {
    const int wid = __builtin_amdgcn_readfirstlane(tid >> 6), lane = tid & 63, wr = wid >> 2, wc = wid & 3, fr = lane & 15, fq = lane >> 4;
    const int K = g.K, nt = K / BK;
    unsigned voffA[2], voffB[2];
#pragma unroll
    for (int i = 0; i < 2; ++i) { int R, C; stage_rc(tid * 16 + i * 8192, R, C); const int Rb = Epi::PERM ? ((R & ~31) + perm32(R & 31)) : R;
        voffA[i] = (unsigned)(R * K + C) * 2u; voffB[i] = (unsigned)(Rb * K + C) * 2u; }
    const size_t kstep = (size_t)(BK * 2);
    const size_t hstep = (size_t)HALF * K * 2;
    const size_t tstep = 2 * hstep;
    const unsigned ldsw = (unsigned)wid * 1024u;
    const int aoff = lds_byte(wr * 64 + fr, fq * 8), boff = lds_byte(wc * 32 + fr, fq * 8);
#define PG8_SA(b, h) (((b) * 2 + (h)) * HTB)
#define PG8_SB(b, h) ((4 + (b) * 2 + (h)) * HTB)
#define PG8_STAGE(bufoff, gbase, voff) do { _Pragma("unroll") for (int _i = 0; _i < 2; ++_i) \
        __builtin_amdgcn_global_load_lds((const unsigned*)((const char*)(gbase) + (voff)[_i]), (PG8_LAS unsigned*)(lds + (bufoff) + ldsw + _i * 8192), 16, 0, 0); } while (0)
#define PG8_LDA(dst, b, h) do { _Pragma("unroll") for (int m = 0; m < 4; ++m) _Pragma("unroll") for (int k = 0; k < 2; ++k) dst[m][k] = *(const PG8_LAS bf16x8*)(lds + PG8_SA(b, h) + aoff + m * 2048 + k * 1024); } while (0)
#define PG8_LDB(dst, b, h) do { _Pragma("unroll") for (int n = 0; n < 2; ++n) _Pragma("unroll") for (int k = 0; k < 2; ++k) dst[n][k] = *(const PG8_LAS bf16x8*)(lds + PG8_SB(b, h) + boff + n * 2048 + k * 1024); } while (0)
#define PG8_MMA(ai, bj, At, Bt) do { __builtin_amdgcn_s_setprio(1); _Pragma("unroll") for (int m = 0; m < 4; ++m) _Pragma("unroll") for (int n = 0; n < 2; ++n) _Pragma("unroll") for (int k = 0; k < 2; ++k) \
        acc[ai][bj][m][n] = __builtin_amdgcn_mfma_f32_16x16x32_bf16(Bt[n][k], At[m][k], acc[ai][bj][m][n], 0, 0, 0); __builtin_amdgcn_s_setprio(0); } while (0)
#define PG8_WAIT_V(n) asm volatile("s_waitcnt vmcnt(" #n ")" ::: "memory")
#define PG8_WAIT_L(n) asm volatile("s_waitcnt lgkmcnt(" #n ")" ::: "memory")
#define PG8_BAR __builtin_amdgcn_s_barrier()
#define PG8_SCHED __builtin_amdgcn_sched_barrier(0)
    Unit cur, nxt; int ui = 0;
    if (!S.next(0, cur)) return;
    f32x4 acc[2][2][4][2];
#pragma unroll
    for (int a = 0; a < 2; ++a)
#pragma unroll
        for (int b = 0; b < 2; ++b)
#pragma unroll
            for (int m = 0; m < 4; ++m)
#pragma unroll
                for (int n = 0; n < 2; ++n) acc[a][b][m][n] = (f32x4){0.f, 0.f, 0.f, 0.f};
    bf16x8 At[4][2], B0[2][2], B1[2][2];
    const char* cA = (const char*)g.A + (size_t)cur.pm * tstep; const char* cB = (const char*)g.Bt + (size_t)cur.pn * tstep;
    S.a_ready(cur);
    if constexpr (SP2) {
        PG8_STAGE(PG8_SB(0, 0), cB, voffB); PG8_STAGE(PG8_SB(0, 1), cB + hstep, voffB); PG8_STAGE(PG8_SA(0, 0), cA, voffA); PG8_STAGE(PG8_SA(0, 1), cA + hstep, voffA);
        if (wr == 1) PG8_BAR;
        PG8_WAIT_V(2); PG8_BAR;
        PG8_STAGE(PG8_SB(1, 0), cB + kstep, voffB); PG8_STAGE(PG8_SA(1, 0), cA + kstep, voffA); PG8_STAGE(PG8_SB(1, 1), cB + hstep + kstep, voffB);
        PG8_WAIT_V(6); PG8_BAR;
    } else {
        PG8_STAGE(PG8_SB(0, 0), cB, voffB); PG8_STAGE(PG8_SA(0, 0), cA, voffA); PG8_STAGE(PG8_SB(0, 1), cB + hstep, voffB); PG8_STAGE(PG8_SA(0, 1), cA + hstep, voffA);
        if (wr == 1) PG8_BAR;
        PG8_WAIT_V(4); PG8_BAR;
        PG8_STAGE(PG8_SB(1, 0), cB + kstep, voffB); PG8_STAGE(PG8_SA(1, 0), cA + kstep, voffA); PG8_STAGE(PG8_SB(1, 1), cB + hstep + kstep, voffB);
        PG8_WAIT_V(6); PG8_BAR;
    }
    for (;;) {
        const bool has_next = S.next(ui + 1, nxt);
        const char* nA = has_next ? (const char*)g.A + (size_t)nxt.pm * tstep : cA; const char* nB = has_next ? (const char*)g.Bt + (size_t)nxt.pn * tstep : cB;
        for (int t = 0; t < nt; t += 2) {
            const bool last = (t == nt - 2);
            const char* a1 = cA + (size_t)(t + 1) * kstep;
            const char* a2 = last ? nA : cA + (size_t)(t + 2) * kstep; const char* b2 = last ? nB : cB + (size_t)(t + 2) * kstep;
            const char* a3 = a2 + kstep; const char* b3 = b2 + kstep;
            if (last && has_next) S.a_ready(nxt);
            if constexpr (SP2) {
            PG8_LDB(B0, 0, 0); PG8_LDB(B1, 0, 1); PG8_SCHED; PG8_LDA(At, 0, 0); PG8_STAGE(PG8_SA(1, 1), a1 + hstep, voffA);
            PG8_WAIT_V(8); PG8_WAIT_L(0); PG8_BAR; PG8_MMA(0, 0, At, B0); PG8_MMA(0, 1, At, B1); PG8_BAR; PG8_SCHED;
            PG8_LDA(At, 0, 1); PG8_STAGE(PG8_SB(0, 0), b2, voffB); PG8_STAGE(PG8_SB(0, 1), b2 + hstep, voffB); PG8_STAGE(PG8_SA(0, 0), a2, voffA);
            PG8_WAIT_V(8); PG8_WAIT_L(0); PG8_BAR; PG8_MMA(1, 0, At, B0); PG8_MMA(1, 1, At, B1); PG8_BAR; PG8_SCHED;
            PG8_LDB(B0, 1, 0); PG8_LDB(B1, 1, 1); PG8_SCHED; PG8_LDA(At, 1, 0); PG8_STAGE(PG8_SA(0, 1), a2 + hstep, voffA);
            PG8_WAIT_V(8); PG8_WAIT_L(0); PG8_BAR; PG8_MMA(0, 0, At, B0); PG8_MMA(0, 1, At, B1); PG8_BAR; PG8_SCHED;
            PG8_LDA(At, 1, 1); PG8_STAGE(PG8_SB(1, 0), b3, voffB); PG8_STAGE(PG8_SB(1, 1), b3 + hstep, voffB); PG8_STAGE(PG8_SA(1, 0), a3, voffA);
            PG8_WAIT_V(8); PG8_WAIT_L(0); PG8_BAR; PG8_MMA(1, 0, At, B0); PG8_MMA(1, 1, At, B1); PG8_BAR; PG8_SCHED;
            } else {
            PG8_LDB(B0, 0, 0); PG8_SCHED; PG8_LDA(At, 0, 0); PG8_STAGE(PG8_SA(1, 1), a1 + hstep, voffA);
            PG8_WAIT_L(8); PG8_BAR; PG8_WAIT_L(0); PG8_MMA(0, 0, At, B0); PG8_BAR; PG8_SCHED;
            PG8_LDB(B1, 0, 1); PG8_STAGE(PG8_SB(0, 0), b2, voffB);
            PG8_BAR; PG8_WAIT_L(0); PG8_MMA(0, 1, At, B1); PG8_BAR;
            PG8_LDA(At, 0, 1); PG8_STAGE(PG8_SA(0, 0), a2, voffA);
            PG8_BAR; PG8_WAIT_L(0); PG8_MMA(1, 0, At, B0); PG8_BAR; PG8_SCHED;
            PG8_STAGE(PG8_SB(0, 1), b2 + hstep, voffB);
            PG8_WAIT_V(6); PG8_BAR; PG8_MMA(1, 1, At, B1); PG8_BAR;
            PG8_LDB(B0, 1, 0); PG8_SCHED; PG8_LDA(At, 1, 0); PG8_STAGE(PG8_SA(0, 1), a2 + hstep, voffA);
            PG8_WAIT_L(8); PG8_BAR; PG8_WAIT_L(0); PG8_MMA(0, 0, At, B0); PG8_BAR; PG8_SCHED;
            PG8_LDB(B1, 1, 1); PG8_STAGE(PG8_SB(1, 0), b3, voffB);
            PG8_BAR; PG8_WAIT_L(0); PG8_MMA(0, 1, At, B1); PG8_BAR;
            PG8_LDA(At, 1, 1); PG8_STAGE(PG8_SA(1, 0), a3, voffA);
            PG8_BAR; PG8_WAIT_L(0); PG8_MMA(1, 0, At, B0); PG8_BAR; PG8_SCHED;
            PG8_STAGE(PG8_SB(1, 1), b3 + hstep, voffB);
            PG8_WAIT_V(6); PG8_BAR; PG8_MMA(1, 1, At, B1); PG8_BAR;
            }
        }
        if constexpr (ALIGN_EPI) { if (wr == 0) PG8_BAR; }
        if constexpr (!Epi::AFTER_DRAIN) { E(acc, cur, wr, wc, fr, fq); S.done(cur); }
        if (!has_next) break;
#pragma unroll
        for (int a = 0; a < 2; ++a)
#pragma unroll
            for (int b = 0; b < 2; ++b)
#pragma unroll
                for (int m = 0; m < 4; ++m)
#pragma unroll
                    for (int n = 0; n < 2; ++n) acc[a][b][m][n] = (f32x4){0.f, 0.f, 0.f, 0.f};
        cur = nxt; cA = nA; cB = nB; ++ui;
        if constexpr (ALIGN_EPI) { if (wr == 1) PG8_BAR; }
    }
    PG8_WAIT_V(0);
    if constexpr (!ALIGN_EPI) { if (wr == 0) PG8_BAR; }
    PG8_BAR;
#undef PG8_SA
#undef PG8_SB
#undef PG8_STAGE
#undef PG8_LDA
#undef PG8_LDB
#undef PG8_MMA
#undef PG8_WAIT_V
#undef PG8_WAIT_L
#undef PG8_BAR
#undef PG8_SCHED
}
}

constexpr int NWAVES = 8;
constexpr int DM = 1024, SEQ = 16384, NSAMP = 1024, RT = SEQ + NSAMP, FF = 4096;
constexpr int NZ = 1792, NKVQ = 2560;
constexpr float EPS = 1e-6f;
constexpr int NPHASE = 15;

constexpr size_t MiB = 1u << 20;
constexpr size_t WS_CTL = 0, CTL_ZERO_BYTES = 64 * 1024;
constexpr size_t WS_INA = 1 * MiB;
constexpr size_t WS_OUTA = WS_INA + (size_t)NZ * DM * 2;
constexpr size_t WS_FF1 = WS_OUTA + (size_t)DM * DM * 2;
constexpr size_t WS_FF2 = WS_FF1 + 2 * (size_t)FF * DM * 2;
constexpr size_t WS_KVINB = WS_FF2 + 2 * (size_t)FF * DM * 2;
constexpr size_t WS_OUTB = WS_KVINB + (size_t)NKVQ * DM * 2;
constexpr size_t WS_WMEM = WS_OUTB + (size_t)DM * DM * 2;
constexpr size_t WS_WSB = WS_WMEM + (size_t)DM * DM * 2;
constexpr size_t WS_MEMN = WS_WSB + 4 * 128 * 128 * 2;
constexpr size_t WS_MEMKV = WS_MEMN + 256 * 1024 * 2;
constexpr size_t WS_XN = 50 * MiB;
constexpr size_t WS_Y = 84 * MiB;
constexpr size_t WS_A2 = 118 * MiB;
constexpr size_t WS_BIG = 152 * MiB;
constexpr size_t WS_H = WS_A2;
constexpr size_t WS_END = 254 * MiB;
static_assert(WS_MEMKV + 2 * 256 * 512 * 2 <= WS_XN, "weights region");
static_assert(WS_BIG + (size_t)RT * NKVQ * 2 <= WS_END && WS_H + (size_t)RT * FF * 2 <= WS_END, "ws map");
constexpr int CW_BAR = 1024;

constexpr int RING_BYTES = 131072;
constexpr int LDSCTL_OFF = RING_BYTES, MISC_OFF = LDSCTL_OFF + 320;
constexpr int LDS_BYTES = 147456;

#define GAS __attribute__((address_space(1)))
#define LAS __attribute__((address_space(3)))
typedef unsigned short bf16;
typedef unsigned v4u __attribute__((ext_vector_type(4)));
typedef unsigned v2u __attribute__((ext_vector_type(2)));
typedef float f32x4 __attribute__((ext_vector_type(4)));
typedef float f32x16 __attribute__((ext_vector_type(16)));
typedef short bf16x8 __attribute__((ext_vector_type(8)));
typedef short s16x4 __attribute__((ext_vector_type(4)));
typedef GAS unsigned gu32;
#define RLX_AGENT __ATOMIC_RELAXED, __HIP_MEMORY_SCOPE_AGENT
#define LDS_WAIT() asm volatile("s_waitcnt lgkmcnt(0)" ::: "memory")

__device__ __forceinline__ unsigned f2bf(float f) { unsigned u = __builtin_bit_cast(unsigned, f); return (u + 0x7fffu + ((u >> 16) & 1u)) >> 16; }
__device__ __forceinline__ unsigned pk2(float lo, float hi) { return pg8::cvt_pk_bf16(lo, hi); }
__device__ __forceinline__ float u2f(unsigned u) { return __builtin_bit_cast(float, u); }
__device__ __forceinline__ float bflo(unsigned w) { return __builtin_bit_cast(float, w << 16); }
__device__ __forceinline__ float bfhi(unsigned w) { return __builtin_bit_cast(float, w & 0xffff0000u); }

#define XB_TMO      128
#define XB_XCNT(j)  (256  + 64 * (j))
#define XB_XSUB(j)  (1280 + 64 * (j))
#define XB_XGEN(j)  (2304 + 64 * (j))
#define XB_TOP      3328
#define XB_TOPGEN   3392
#define XCD_BAR_WORDS 3456
#define XB_SPIN_CAP (1u << 18)
__device__ __forceinline__ unsigned xb_ld(unsigned* p)              { return __hip_atomic_load(p, __ATOMIC_RELAXED, __HIP_MEMORY_SCOPE_AGENT); }
__device__ __forceinline__ unsigned xb_add(unsigned* p, unsigned v) { return __hip_atomic_fetch_add(p, v, __ATOMIC_RELAXED, __HIP_MEMORY_SCOPE_AGENT); }
__device__ __forceinline__ unsigned xb_xcc_id() { return (unsigned)__builtin_amdgcn_s_getreg((3 << 11) | 20) & 0xFu; }
#define XB_SPIN(cond, bar) do { unsigned _sp = 0; while (cond) { __builtin_amdgcn_s_sleep(1); \
    if ((++_sp & 255u) == 0u) { if (xb_ld(&(bar)[XB_TMO])) break; if (_sp > XB_SPIN_CAP) { atomicAdd(&(bar)[XB_TMO], 1u); break; } } } } while (0)
struct XcdBarrier { unsigned* bar; unsigned x; volatile LAS unsigned* st; };
__device__ __forceinline__ XcdBarrier xcd_barrier_post(unsigned* bar, volatile LAS unsigned* st) {
    XcdBarrier b; b.bar = bar; b.x = xb_xcc_id(); b.st = st;
    if (threadIdx.x == 0) (void)xb_add(&bar[XB_XCNT(b.x)], 1u);
    return b;
}
__device__ __forceinline__ void xcd_barrier_complete(unsigned* bar, unsigned x, unsigned& nloc, unsigned& nx) {
    const unsigned G = gridDim.x * gridDim.y * gridDim.z;
    unsigned sum, cnt, mine, sp = 0u;
    for (;;) {
        sum = 0u; cnt = 0u; mine = 0u;
#pragma unroll
        for (unsigned j = 0; j < 16; ++j) { const unsigned c = xb_ld(&bar[XB_XCNT(j)]); sum += c; cnt += (c > 0u) ? 1u : 0u; mine = (j == x) ? c : mine; }
        if (sum == G) break;
        __builtin_amdgcn_s_sleep(1);
        if ((++sp & 255u) == 0u) { if (xb_ld(&bar[XB_TMO])) break; if (sp > XB_SPIN_CAP) { atomicAdd(&bar[XB_TMO], 1u); break; } }
    }
    nloc = mine > 0u ? mine : 1u; nx = cnt > 0u ? cnt : 1u;
}
__device__ __forceinline__ void xcd_barrier(const XcdBarrier& b) {
    asm volatile("s_waitcnt vmcnt(0)" ::: "memory");
    __syncthreads();
    if (threadIdx.x == 0) {
        unsigned* bar = b.bar;
        __builtin_amdgcn_s_waitcnt(0);
        unsigned nloc = b.st[0], nx = b.st[1];
        if (nloc == 0u) { xcd_barrier_complete(bar, b.x, nloc, nx); b.st[0] = nloc; b.st[1] = nx; }
        const unsigned old = xb_add(&bar[XB_XSUB(b.x)], 1u);
        const unsigned gen = old / nloc;
        if (old + 1u == (gen + 1u) * nloc) {
            __builtin_amdgcn_fence(__ATOMIC_RELEASE, "agent");
            asm volatile("s_waitcnt vmcnt(0)" ::: "memory");
            const unsigned og = xb_add(&bar[XB_TOP], 1u);
            const unsigned tg = og / nx;
            if (og + 1u == (tg + 1u) * nx) xb_add(&bar[XB_TOPGEN], 1u);
            else XB_SPIN(xb_ld(&bar[XB_TOPGEN]) == tg, bar);
            __builtin_amdgcn_fence(__ATOMIC_ACQUIRE, "agent");
            xb_add(&bar[XB_XGEN(b.x)], 1u);
            asm volatile("s_waitcnt vmcnt(0)" ::: "memory");
        } else {
            XB_SPIN(xb_ld(&bar[XB_XGEN(b.x)]) == gen, bar);
            __builtin_amdgcn_fence(__ATOMIC_ACQUIRE, "agent");
            asm volatile("s_waitcnt vmcnt(0)" ::: "memory");
        }
    }
    __syncthreads();
}

__device__ __forceinline__ float wave_sum(float v) {
#pragma unroll
    for (int o = 1; o < 64; o <<= 1) v += __shfl_xor(v, o);
    return v;
}
__device__ __forceinline__ void p0_transpose_item(const float* W, const float* gain, int K, int N, bf16* WT, int row_off, LAS float* scr, int item, int lane) {
    const int nblk = N / 32, kb = item / nblk, nb = item % nblk, k0 = 64 * kb, n0 = 32 * nb;
#pragma unroll 8
    for (int i = 0; i < 32; ++i) { const int kk = 2 * i + (lane >> 5); const float g = gain ? gain[k0 + kk] : 1.0f; scr[kk * 33 + (lane & 31)] = W[(size_t)(k0 + kk) * N + n0 + (lane & 31)] * g; }
    LDS_WAIT(); asm volatile("" ::: "memory");
    const int c = lane & 7;
#pragma unroll
    for (int j = 0; j < 4; ++j) { const int n = (lane >> 3) + 8 * j; const LAS float* s = scr + (8 * c) * 33 + n;
        v4u o; o.x = pk2(s[0 * 33], s[1 * 33]); o.y = pk2(s[2 * 33], s[3 * 33]); o.z = pk2(s[4 * 33], s[5 * 33]); o.w = pk2(s[6 * 33], s[7 * 33]);
        *(GAS v4u*)(WT + (size_t)(row_off + n0 + n) * K + k0 + 8 * c) = o; }
    LDS_WAIT(); asm volatile("" ::: "memory");
}
__device__ __forceinline__ void rms_row_to_bf16(const float* xrow, bf16* orow, int lane) {
    const GAS f32x4* xr = (const GAS f32x4*)xrow + lane;
    f32x4 v[4]; float s = 0.f;
#pragma unroll
    for (int j = 0; j < 4; ++j) { v[j] = xr[64 * j]; s += (v[j].x * v[j].x + v[j].y * v[j].y) + (v[j].z * v[j].z + v[j].w * v[j].w); }
    const float rs = 1.0f / sqrtf(wave_sum(s) * (1.f / DM) + EPS);
    GAS v2u* o8 = (GAS v2u*)orow + lane;
#pragma unroll
    for (int j = 0; j < 4; ++j) { v2u w; w.x = pk2(v[j].x * rs, v[j].y * rs); w.y = pk2(v[j].z * rs, v[j].w * rs); o8[64 * j] = w; }
}
__device__ __forceinline__ void norm_row(const bf16* yrow, const float* xin, const float* gpost, float* xout, bf16* xn, int lane) {
    const GAS v2u* yr = (const GAS v2u*)yrow + lane; const GAS f32x4* xr = (const GAS f32x4*)xin + lane; const GAS f32x4* gr = (const GAS f32x4*)gpost + lane;
    f32x4 y[4], x[4]; float s = 0.f;
#pragma unroll
    for (int j = 0; j < 4; ++j) { const v2u w = yr[64 * j]; y[j] = (f32x4){bflo(w.x), bfhi(w.x), bflo(w.y), bfhi(w.y)}; x[j] = xr[64 * j];
        s += (y[j].x * y[j].x + y[j].y * y[j].y) + (y[j].z * y[j].z + y[j].w * y[j].w); }
    const float ry = 1.0f / sqrtf(wave_sum(s) * (1.f / DM) + EPS);
    float s1 = 0.f;
#pragma unroll
    for (int j = 0; j < 4; ++j) { const f32x4 g = gr[64 * j]; x[j] = x[j] + y[j] * ry * g; s1 += (x[j].x * x[j].x + x[j].y * x[j].y) + (x[j].z * x[j].z + x[j].w * x[j].w); }
    GAS f32x4* xo = (GAS f32x4*)xout + lane;
#pragma unroll
    for (int j = 0; j < 4; ++j) xo[64 * j] = x[j];
    if (xn) {
        const float r1 = 1.0f / sqrtf(wave_sum(s1) * (1.f / DM) + EPS);
        GAS v2u* o8 = (GAS v2u*)xn + lane;
#pragma unroll
        for (int j = 0; j < 4; ++j) { v2u w; w.x = pk2(x[j].x * r1, x[j].y * r1); w.y = pk2(x[j].z * r1, x[j].w * r1); o8[64 * j] = w; }
    }
}

__device__ __forceinline__ int crow(int r, int hi) { return (r & 3) + 8 * (r >> 2) + 4 * hi; }
__device__ __forceinline__ s16x4 ldtr(const LAS unsigned char* p) {
    typedef short v4i16_t __attribute__((ext_vector_type(4)));
    return __builtin_bit_cast(s16x4, __builtin_amdgcn_ds_read_tr16_b64_v4i16((LAS v4i16_t*)p));
}
__device__ __forceinline__ bf16x8 cat8(s16x4 a, s16x4 b) { return (bf16x8){a[0], a[1], a[2], a[3], b[0], b[1], b[2], b[3]}; }
__device__ __forceinline__ v4u pack8(const float* x) { v4u w; w.x = pk2(x[0], x[1]); w.y = pk2(x[2], x[3]); w.z = pk2(x[4], x[5]); w.w = pk2(x[6], x[7]); return w; }

constexpr int SP_STRIDE = 832;
__device__ __forceinline__ void spatial_unit(LAS unsigned char* lds, int tid, int r0, int gp, bool sample, const bf16* Z, bf16* A2, const bf16* WSB,
                                             const float* g_ln, const float* b_ln, const float* b_sp, float* vout) {
    const int lane = tid & 63, wid = __builtin_amdgcn_readfirstlane(tid >> 6);
    __syncthreads();
#pragma unroll 1
    for (int it = 0; it < 4; ++it) {
        const int pi = it * 64 + wid * 8 + (lane >> 3), t = pi >> 1, gl = pi & 1, j8 = lane & 7, g = 2 * gp + gl;
        const bf16* src = Z + (size_t)(r0 + t) * NZ + 768 + g * 192;
        float x[24]; float s = 0.f;
#pragma unroll
        for (int i = 0; i < 3; ++i) { const v4u w = *(const GAS v4u*)(src + (j8 + 8 * i) * 8);
            x[8 * i + 0] = bflo(w.x); x[8 * i + 1] = bfhi(w.x); x[8 * i + 2] = bflo(w.y); x[8 * i + 3] = bfhi(w.y);
            x[8 * i + 4] = bflo(w.z); x[8 * i + 5] = bfhi(w.z); x[8 * i + 6] = bflo(w.w); x[8 * i + 7] = bfhi(w.w); }
#pragma unroll
        for (int e = 0; e < 24; ++e) s += x[e];
        s += __shfl_xor(s, 1); s += __shfl_xor(s, 2); s += __shfl_xor(s, 4);
        const float mean = s * (1.0f / 192.0f); float q = 0.f;
#pragma unroll
        for (int e = 0; e < 24; ++e) { x[e] -= mean; q += x[e] * x[e]; }
        q += __shfl_xor(q, 1); q += __shfl_xor(q, 2); q += __shfl_xor(q, 4);
        const float rstd = 1.0f / sqrtf(q * (1.0f / 192.0f) + EPS);
#pragma unroll
        for (int i = 0; i < 3; ++i) { const int c0 = (j8 + 8 * i) * 8, C = g * 192 + c0; float v[8];
            const f32x4 ga = *(const GAS f32x4*)(g_ln + C), gb = *(const GAS f32x4*)(g_ln + C + 4), ba = *(const GAS f32x4*)(b_ln + C), bb = *(const GAS f32x4*)(b_ln + C + 4);
#pragma unroll
            for (int e = 0; e < 4; ++e) { v[e] = x[8 * i + e] * rstd * ga[e] + ba[e]; v[4 + e] = x[8 * i + 4 + e] * rstd * gb[e] + bb[e]; }
            *(LAS v4u*)(lds + t * SP_STRIDE + (gl * 192 + c0) * 2) = pack8(v);
            if (vout) { float* vo = vout + (size_t)(r0 + t - SEQ) * 768 + C; *(GAS f32x4*)vo = (f32x4){v[0], v[1], v[2], v[3]}; *(GAS f32x4*)(vo + 4) = (f32x4){v[4], v[5], v[6], v[7]}; }
        }
    }
    __syncthreads();
    const int gl = wid >> 2, wq = wid & 3, g = 2 * gp + gl, l31 = lane & 31, hi = lane >> 5;
#pragma unroll 1
    for (int i = 0; i < 3; ++i) {
        const int idx = wq * 3 + i, cblk = idx % 6, pair = idx / 6;
#pragma unroll 1
        for (int half = 0; half < 2; ++half) {
            const int tb = pair == 0 ? (half ? 3 : 0) : (half ? 2 : 1);
            f32x16 acc = {};
            const int sb_lo = sample ? tb : 0;
            const int trow = (sample ? 0 : 32 * tb) + l31;
#pragma unroll 1
            for (int sb = sb_lo; sb <= tb; ++sb) {
#pragma unroll
                for (int kk = 0; kk < 2; ++kk) {
                    const LAS unsigned char* ap = lds + (32 * sb + 16 * kk + 8 * hi + ((lane & 15) >> 2)) * SP_STRIDE + (gl * 192 + 32 * cblk + 16 * ((lane >> 4) & 1) + 4 * (lane & 3)) * 2;
                    const bf16x8 a = cat8(ldtr(ap), ldtr(ap + 4 * SP_STRIDE));
                    const bf16x8 b = *(const GAS bf16x8*)(WSB + ((size_t)g * 128 + trow) * 128 + (sample ? 0 : 32 * sb) + 16 * kk + 8 * hi);
                    acc = __builtin_amdgcn_mfma_f32_32x32x16_bf16(a, b, acc, 0, 0, 0);
                }
            }
            const int row = r0 + 32 * tb + l31;
            const float bs = b_sp[g * 128 + (sample ? l31 : 32 * tb + l31)];
#pragma unroll
            for (int i4 = 0; i4 < 4; ++i4) { const int C = g * 192 + 32 * cblk + 8 * i4 + 4 * hi;
                const v2u uw = *(const GAS v2u*)(Z + (size_t)row * NZ + C);
                v2u o; o.x = pk2(bflo(uw.x) * (acc[4 * i4 + 0] + bs), bfhi(uw.x) * (acc[4 * i4 + 1] + bs)); o.y = pk2(bflo(uw.y) * (acc[4 * i4 + 2] + bs), bfhi(uw.y) * (acc[4 * i4 + 3] + bs));
                *(GAS v2u*)(A2 + (size_t)row * DM + C) = o; }
        }
    }
}

struct KVTile { const unsigned char* k; const unsigned char* v; int pitchB; int f32; int rmask; };
constexpr float C2 = 0.125f * 1.4426950408889634f;
constexpr float LOG2E = 1.4426950408889634f;
constexpr int AT_V = 34816, AT_BIAS = 73728, AT_WSF = 76800;

template <int TC, bool BIAS, class TileFn>
__device__ __forceinline__ void attn_unit(LAS unsigned char* lds, int tid, const TileFn TF, int jt0, int jt1,
                                          const bf16* qptr, bool active, int t_lo, int t_hi, int kvoff, int nvalid_last, int relq_tq,
                                          const float* rbg  , int bias_sel, bf16* optr) {
    constexpr int SK = TC * 2 + 16, SV = TC * 2 + 64, CPR = TC / 8, NP = 64 * CPR / 512;
    const int lane = tid & 63, wid = __builtin_amdgcn_readfirstlane(tid >> 6), l31 = lane & 31, hi = lane >> 5;
    LAS unsigned char* Kl = lds; LAS unsigned char* Vl = lds + AT_V;
    LAS float* bl = (LAS float*)(lds + AT_BIAS) + bias_sel * 257;
    LAS float* wsf = (LAS float*)(lds + AT_WSF) + wid * 32;
    __syncthreads();
    if (BIAS) { for (int i = tid; i < 514; i += 512) ((LAS float*)(lds + AT_BIAS))[i] = rbg[i] * LOG2E; }
    bf16x8 qf[4];
#pragma unroll
    for (int ks = 0; ks < 4; ++ks) qf[ks] = *(const GAS bf16x8*)(qptr + 16 * ks + 8 * hi);
    f32x16 o0 = {}, o1 = {}; float m = -INFINITY, l = 0.f;
    v4u sk[NP][2], sv[NP][2];
    KVTile T = TF(jt0); int stf32 = T.f32;
#define AT_LOAD() do { _Pragma("unroll") for (int p = 0; p < NP; ++p) { const int i_ = tid + 512 * p, row_ = i_ / CPR, ch_ = i_ % CPR, rr_ = row_ & T.rmask; \
        if (T.f32) { const unsigned char* kp_ = T.k + (size_t)rr_ * T.pitchB + ch_ * 32; const unsigned char* vp_ = T.v + (size_t)rr_ * T.pitchB + ch_ * 32; \
            sk[p][0] = *(const GAS v4u*)kp_; sk[p][1] = *(const GAS v4u*)(kp_ + 16); sv[p][0] = *(const GAS v4u*)vp_; sv[p][1] = *(const GAS v4u*)(vp_ + 16); } \
        else { sk[p][0] = *(const GAS v4u*)(T.k + (size_t)rr_ * T.pitchB + ch_ * 16); sv[p][0] = *(const GAS v4u*)(T.v + (size_t)rr_ * T.pitchB + ch_ * 16); sk[p][1] = sk[p][0]; sv[p][1] = sv[p][0]; } } } while (0)
    AT_LOAD();
#pragma unroll 1
    for (int jt = jt0; jt < jt1; ++jt) {
        __syncthreads();
#pragma unroll
        for (int p = 0; p < NP; ++p) { const int i_ = tid + 512 * p, row_ = i_ / CPR, ch_ = i_ % CPR; v4u wk = sk[p][0], wv = sv[p][0];
            if (stf32) { const v4u a = sk[p][0], b = sk[p][1], c = sv[p][0], d = sv[p][1];
                wk.x = pk2(u2f(a.x), u2f(a.y)); wk.y = pk2(u2f(a.z), u2f(a.w)); wk.z = pk2(u2f(b.x), u2f(b.y)); wk.w = pk2(u2f(b.z), u2f(b.w));
                wv.x = pk2(u2f(c.x), u2f(c.y)); wv.y = pk2(u2f(c.z), u2f(c.w)); wv.z = pk2(u2f(d.x), u2f(d.y)); wv.w = pk2(u2f(d.z), u2f(d.w)); }
            *(LAS v4u*)(Kl + row_ * SK + ch_ * 16) = wk; *(LAS v4u*)(Vl + row_ * SV + ch_ * 16) = wv; }
        __syncthreads();
        if (jt + 1 < jt1) { T = TF(jt + 1); stf32 = T.f32; AT_LOAD(); }
        if (active && jt >= t_lo && jt <= t_hi) {
            const LAS unsigned char* kb = Kl + l31 * SK + (kvoff + 8 * hi) * 2;
            f32x16 p0 = {}, p1 = {};
#pragma unroll
            for (int ks = 0; ks < 4; ++ks) { const bf16x8 a0 = *(const LAS bf16x8*)(kb + ks * 32), a1 = *(const LAS bf16x8*)(kb + 32 * SK + ks * 32);
                p0 = __builtin_amdgcn_mfma_f32_32x32x16_bf16(a0, qf[ks], p0, 0, 0, 0); p1 = __builtin_amdgcn_mfma_f32_32x32x16_bf16(a1, qf[ks], p1, 0, 0, 0); }
            const int relb = relq_tq - 64 * jt;
            const bool lastt = (jt == jt1 - 1) && (nvalid_last < 64);
            float mx = -INFINITY;
#pragma unroll
            for (int r = 0; r < 16; ++r) { const int j0 = crow(r, hi);
                float s0 = p0[r] * C2, s1 = p1[r] * C2;
                if (BIAS) { int i0 = relb - j0, i1 = i0 - 32; i0 = i0 < -128 ? -128 : (i0 > 128 ? 128 : i0); i1 = i1 < -128 ? -128 : (i1 > 128 ? 128 : i1); s0 += bl[i0 + 128]; s1 += bl[i1 + 128]; }
                if (lastt) { if (j0 >= nvalid_last) s0 = -INFINITY; if (j0 + 32 >= nvalid_last) s1 = -INFINITY; }
                p0[r] = s0; p1[r] = s1; mx = fmaxf(mx, fmaxf(s0, s1)); }
            mx = fmaxf(mx, __shfl_xor(mx, 32));
            const float mn = fmaxf(m, mx), f = __builtin_amdgcn_exp2f(m - mn); m = mn;
            float rs = 0.f;
#pragma unroll
            for (int r = 0; r < 16; ++r) { p0[r] = __builtin_amdgcn_exp2f(p0[r] - mn); p1[r] = __builtin_amdgcn_exp2f(p1[r] - mn); rs += p0[r] + p1[r]; }
            l = l * f + rs;
            if (hi == 0) wsf[l31] = f;
            bf16x8 pa[4];
            { float t8[8];
#pragma unroll
              for (int e = 0; e < 8; ++e) t8[e] = p0[e];
              pa[0] = __builtin_bit_cast(bf16x8, pack8(t8));
#pragma unroll
              for (int e = 0; e < 8; ++e) t8[e] = p0[8 + e];
              pa[1] = __builtin_bit_cast(bf16x8, pack8(t8));
#pragma unroll
              for (int e = 0; e < 8; ++e) t8[e] = p1[e];
              pa[2] = __builtin_bit_cast(bf16x8, pack8(t8));
#pragma unroll
              for (int e = 0; e < 8; ++e) t8[e] = p1[8 + e];
              pa[3] = __builtin_bit_cast(bf16x8, pack8(t8)); }
#pragma unroll
            for (int r = 0; r < 16; ++r) { const float fr_ = wsf[crow(r, hi)]; o0[r] *= fr_; o1[r] *= fr_; }
            const LAS unsigned char* vb = Vl + (4 * hi + ((lane & 15) >> 2)) * SV + (kvoff + 16 * ((lane >> 4) & 1) + 4 * (lane & 3)) * 2;
#pragma unroll
            for (int kk = 0; kk < 4; ++kk) {
                const bf16x8 b0 = cat8(ldtr(vb + kk * 16 * SV), ldtr(vb + kk * 16 * SV + 8 * SV));
                const bf16x8 b1 = cat8(ldtr(vb + kk * 16 * SV + 64), ldtr(vb + kk * 16 * SV + 8 * SV + 64));
                o0 = __builtin_amdgcn_mfma_f32_32x32x16_bf16(pa[kk], b0, o0, 0, 0, 0);
                o1 = __builtin_amdgcn_mfma_f32_32x32x16_bf16(pa[kk], b1, o1, 0, 0, 0);
            }
        }
    }
#undef AT_LOAD
    if (active) {
        const float lt = l + __shfl_xor(l, 32);
        if (hi == 0) wsf[l31] = 1.0f / lt;
#pragma unroll
        for (int r = 0; r < 16; ++r) { const int q = crow(r, hi); const float rl = wsf[q];
            optr[(size_t)q * DM + l31] = (bf16)f2bf(o0[r] * rl); optr[(size_t)q * DM + 32 + l31] = (bf16)f2bf(o1[r] * rl); }
    }
}

struct TileBandP { const bf16* kvq; int ck0; int hp; __device__ __forceinline__ KVTile operator()(int jt) const {
    KVTile T; const bf16* b = kvq + (size_t)(64 * (ck0 + jt)) * NKVQ + 128 * hp; T.k = (const unsigned char*)b; T.v = (const unsigned char*)(b + 768); T.pitchB = NKVQ * 2; T.f32 = 0; T.rmask = 63; return T; } };
struct TileBandS { const bf16* kvq; const float* ck; const float* cv; int b; int hp; __device__ __forceinline__ KVTile operator()(int jt) const {
    KVTile T;
    if (jt < 8) { const size_t off = ((size_t)(b * 512 + 64 * jt)) * 768 + 128 * hp; T.k = (const unsigned char*)(ck + off); T.v = (const unsigned char*)(cv + off); T.pitchB = 768 * 4; T.f32 = 1; T.rmask = 63; }
    else { const bf16* p = kvq + (size_t)(SEQ + 32 * b) * NKVQ + 128 * hp; T.k = (const unsigned char*)p; T.v = (const unsigned char*)(p + 768); T.pitchB = NKVQ * 2; T.f32 = 0; T.rmask = 31; }
    return T; } };
struct TileMemP { const bf16* mkv; int hp; __device__ __forceinline__ KVTile operator()(int jt) const {
    KVTile T; const bf16* p = mkv + (size_t)(64 * jt) * 512 + 128 * hp; T.k = (const unsigned char*)p; T.v = (const unsigned char*)(p + 256); T.pitchB = 1024; T.f32 = 0; T.rmask = 63; return T; } };
struct TileMemS { const float* ck; const float* cv; int hp; __device__ __forceinline__ KVTile operator()(int jt) const {
    KVTile T; T.k = (const unsigned char*)(ck + (size_t)(64 * jt) * 256 + 128 * hp); T.v = (const unsigned char*)(cv + (size_t)(64 * jt) * 256 + 128 * hp); T.pitchB = 1024; T.f32 = 1; T.rmask = 63; return T; } };

__device__ __forceinline__ void mem_units(LAS unsigned char* lds, int tid, int G, int c, int ustart, int layer, const bf16* Q, int qpitch, int qcol,
                                          const bf16* MEMKV, const float* cmk, const float* cmv, bf16* A2) {
    const int wid = __builtin_amdgcn_readfirstlane(tid >> 6), lane = tid & 63, l31 = lane & 31;
    const int hs = wid >> 2, qsel = wid & 3;
    for (int u = ustart + ((c - ustart) % G + G) % G; u < ustart + 320; u += G) {
        const int um = u - ustart;
        if (um < 256) {
            const int hp = um & 1, head = 2 * hp + hs, row0 = 128 * (um >> 1) + 32 * qsel;
            TileMemP TF{MEMKV + (size_t)layer * 256 * 512, hp};
            attn_unit<128, false, TileMemP>(lds, tid, TF, 0, 4, Q + (size_t)(row0 + l31) * qpitch + qcol + 64 * head, true, 0, 3, 64 * hs, 64, 0, nullptr, 0,
                                            A2 + (size_t)row0 * DM + 768 + 64 * head);
        } else {
            const int us = um - 256, b = us >> 1, hp = us & 1, head = 2 * hp + hs, row0 = SEQ + 32 * b;
            TileMemS TF{cmk + ((size_t)(layer * 32 + b)) * 256 * 256, cmv + ((size_t)(layer * 32 + b)) * 256 * 256, hp};
            attn_unit<128, false, TileMemS>(lds, tid, TF, 0, 4, Q + (size_t)(row0 + l31) * qpitch + qcol + 64 * head, qsel == 0, 0, 3, 64 * hs, 64, 0, nullptr, 0,
                                            A2 + (size_t)row0 * DM + 768 + 64 * head);
        }
    }
}

struct Args { const float* in[26]; float* out; unsigned char* ws; int ph_lo, ph_hi; };
__device__ __forceinline__ int opq(int x) { asm volatile("" : "+s"(x)); return x; }
#define INP(k) (args.in[opq(k)])
#define WSP(off) ((bf16*)(ws + (off)))
__global__ void __launch_bounds__(NWAVES * 64, 2) mk_fwd(Args args) {
    extern __shared__ __attribute__((aligned(16))) unsigned char lds_raw[];
    LAS unsigned char* lds = (LAS unsigned char*)lds_raw;
    {   volatile LAS unsigned* z = (volatile LAS unsigned*)(lds + LDSCTL_OFF);
        for (int u = threadIdx.x; u < (LDS_BYTES - LDSCTL_OFF) / 4; u += NWAVES * 64) z[u] = 0u; }
    __syncthreads();
    if (MK_ONE_LAUNCH) (void)xcd_barrier_post((unsigned*)(args.ws + WS_CTL) + CW_BAR, (volatile LAS unsigned*)(lds + MISC_OFF) + 8);

#pragma unroll 1
    for (int ph = args.ph_lo; ph < args.ph_hi; ++ph) {
        int tid = threadIdx.x; asm volatile("" : "+v"(tid));
        const int lane = tid & 63, wave = __builtin_amdgcn_readfirstlane(tid >> 6);
        int G = gridDim.x, bx = blockIdx.x; asm volatile("" : "+s"(G), "+s"(bx));
        const int vcu = (G % 8 == 0) ? (bx % 8) * (G / 8) + bx / 8 : bx;
        GAS unsigned char* wsg = (GAS unsigned char*)args.ws; asm volatile("" : "+s"(wsg)); unsigned char* ws = (unsigned char*)wsg;
        GAS float* outg = (GAS float*)args.out; asm volatile("" : "+s"(outg)); float* out = (float*)outg;
        if (ph == 0 && PHON(0)) {
            LAS float* scr = (LAS float*)(lds + wave * 16384);
            const int gw = vcu * NWAVES + wave, NGW = G * NWAVES;
            constexpr int I_INA = 16 * 56, I_SQ = 16 * 32, I_FF1 = 16 * 128, I_FF2 = 64 * 32, I_KV = 16 * 48, I_MEM = 16 * 16;
            constexpr int NITEMS = I_INA + I_SQ + 2 * I_FF1 + 2 * I_FF2 + I_KV + I_SQ + I_SQ + 2 * I_MEM;
            for (int it = gw; it < NITEMS; it += NGW) {
                int r = it;
                if (r < I_INA) { p0_transpose_item(INP(13), INP(7), DM, NZ, WSP(WS_INA), 0, scr, r, lane); continue; } r -= I_INA;
                if (r < I_SQ) { p0_transpose_item(INP(18), nullptr, DM, DM, WSP(WS_OUTA), 0, scr, r, lane); continue; } r -= I_SQ;
                if (r < 2 * I_FF1) { const int l = r / I_FF1; p0_transpose_item(INP(24) + (size_t)l * DM * FF, INP(9) + l * DM, DM, FF, WSP(WS_FF1) + (size_t)l * FF * DM, 0, scr, r % I_FF1, lane); continue; } r -= 2 * I_FF1;
                if (r < 2 * I_FF2) { const int l = r / I_FF2; p0_transpose_item(INP(25) + (size_t)l * DM * FF, nullptr, FF, DM, WSP(WS_FF2) + (size_t)l * FF * DM, 0, scr, r % I_FF2, lane); continue; } r -= 2 * I_FF2;
                if (r < I_KV) { p0_transpose_item(INP(20), INP(19), DM, 1536, WSP(WS_KVINB), 0, scr, r, lane); continue; } r -= I_KV;
                if (r < I_SQ) { p0_transpose_item(INP(21), INP(7) + DM, DM, DM, WSP(WS_KVINB), 1536, scr, r, lane); continue; } r -= I_SQ;
                if (r < I_SQ) { p0_transpose_item(INP(23), nullptr, DM, DM, WSP(WS_OUTB), 0, scr, r, lane); continue; } r -= I_SQ;
                { const int l = r / I_MEM; p0_transpose_item(INP(12) + (size_t)l * DM * 512, INP(11) + l * DM, DM, 512, WSP(WS_WMEM), l * 512, scr, r % I_MEM, lane); }
            }
            { const float* x_prompt = INP(0); const float* x_sample = INP(1); const float* mem_prompt = INP(6); bf16* XN = WSP(WS_XN); bf16* MEMN = WSP(WS_MEMN);
              for (int mrow = gw; mrow < RT + 256; mrow += NGW) {
                if (mrow < SEQ) rms_row_to_bf16(x_prompt + (size_t)mrow * DM, XN + (size_t)mrow * DM, lane);
                else if (mrow < RT) rms_row_to_bf16(x_sample + (size_t)(mrow - SEQ) * DM, XN + (size_t)mrow * DM, lane);
                else rms_row_to_bf16(mem_prompt + (size_t)(mrow - RT) * DM, MEMN + (size_t)(mrow - RT) * DM, lane);
              } }
            { const float* w_spatial = INP(16); bf16* WSB = WSP(WS_WSB);
              for (int e = vcu * 512 + tid; e < 4 * 128 * 128; e += G * 512) { const int sI = e & 127, tI = (e >> 7) & 127; WSB[e] = (bf16)((sI <= tI) ? f2bf(w_spatial[e]) : 0u); } }
        } else if (ph == 1 && PHON(1)) {
            { pg8::Gemm g{WSP(WS_XN), WSP(WS_INA), RT, NZ, DM}; pg8::StaticOrder S; S.init(RT, NZ, G, bx);
              pg8::Epi<1> E{WSP(WS_BIG), NZ, out};
              pg8::gemm_phase<pg8::Epi<1>, pg8::StaticOrder, true, true>(lds, tid, g, S, E); }
            { pg8::Gemm g{WSP(WS_MEMN), WSP(WS_WMEM), 256, DM, DM}; pg8::TailOrder S{G, bx, 4};
              pg8::Epi<4> E{WSP(WS_MEMKV), 512, out};
              pg8::gemm_phase<pg8::Epi<4>, pg8::TailOrder, true, true>(lds, tid, g, S, E); }
        } else if (ph == 2 && PHON(2)) {
            { const bf16* Z = WSP(WS_BIG); bf16* A2 = WSP(WS_A2); const bf16* WSB = WSP(WS_WSB); const float* g_ln = INP(14); const float* b_ln = INP(15); const float* b_sp = INP(17);
              for (int u = bx; u < 272; u += G) {
                if (u < 256) spatial_unit(lds, tid, 128 * (u >> 1), u & 1, false, Z, A2, WSB, g_ln, b_ln, b_sp, nullptr);
                else { const int us = u - 256; spatial_unit(lds, tid, SEQ + 128 * (us >> 1), us & 1, true, Z, A2, WSB, g_ln, b_ln, b_sp, out + pg8::OUT_GV); }
              } }
            mem_units(lds, tid, G, bx, 272, 0, WSP(WS_BIG), NZ, 1536, WSP(WS_MEMKV), INP(2), INP(3), WSP(WS_A2));
            __syncthreads();
        } else if ((ph == 3 || ph == 6 || ph == 10 || ph == 13) && PHON(3)) {
            const bf16* A = (ph == 3 || ph == 10) ? WSP(WS_A2) : WSP(WS_H);
            const bf16* B = ph == 3 ? WSP(WS_OUTA) : ph == 10 ? WSP(WS_OUTB) : ph == 6 ? WSP(WS_FF2) : WSP(WS_FF2) + (size_t)FF * DM;
            const int K = (ph == 3 || ph == 10) ? DM : FF;
            pg8::Gemm g{A, B, RT, DM, K}; pg8::StaticOrder S; S.init(RT, DM, G, bx);
            pg8::Epi<0> E{WSP(WS_Y), DM, out};
            pg8::gemm_phase<pg8::Epi<0>, pg8::StaticOrder, true, true>(lds, tid, g, S, E);
        } else if ((ph == 4 || ph == 7 || ph == 11 || ph == 14) && PHON(4)) {
            const int gw = vcu * NWAVES + wave, NGW = G * NWAVES;
            const float* gp = ph == 4 ? INP(8) : ph == 7 ? INP(10) : ph == 11 ? INP(8) + DM : INP(10) + DM;
            const float* x_prompt = INP(0); const float* x_sample = INP(1); const bf16* Y = WSP(WS_Y); bf16* XN = WSP(WS_XN);
            for (int mrow = gw; mrow < RT; mrow += NGW) {
                const float* xin = (ph == 4) ? (mrow < SEQ ? x_prompt + (size_t)mrow * DM : x_sample + (size_t)(mrow - SEQ) * DM) : out + (size_t)mrow * DM;
                norm_row(Y + (size_t)mrow * DM, xin, gp, out + (size_t)mrow * DM, ph == 14 ? nullptr : XN + (size_t)mrow * DM, lane);
            }
        } else if ((ph == 5 || ph == 12) && PHON(5)) {
            pg8::Gemm g{WSP(WS_XN), ph == 5 ? WSP(WS_FF1) : WSP(WS_FF1) + (size_t)FF * DM, RT, FF, DM}; pg8::StaticOrder S; S.init(RT, FF, G, bx);
            pg8::Epi<2> E{WSP(WS_H), FF, out};
            pg8::gemm_phase<pg8::Epi<2>, pg8::StaticOrder, true, true>(lds, tid, g, S, E);
        } else if (ph == 8 && PHON(8)) {
            pg8::Gemm g{WSP(WS_XN), WSP(WS_KVINB), RT, NKVQ, DM}; pg8::StaticOrder S; S.init(RT, NKVQ, G, bx);
            pg8::Epi<3> E{WSP(WS_BIG), NKVQ, out};
            pg8::gemm_phase<pg8::Epi<3>, pg8::StaticOrder, true, true>(lds, tid, g, S, E);
        } else if (ph == 9 && PHON(9)) {
            { const int l31 = lane & 31, hs = wave >> 2, cs = (wave >> 1) & 1, qb = wave & 1;
              const bf16* KVQ = WSP(WS_BIG); bf16* A2 = WSP(WS_A2); const float* rel_bias = INP(22); const float* cbk = INP(4); const float* cbv = INP(5);
              for (int u = bx; u < 768 + 192; u += G) {
                if (u < 768) {
                    const int cp = u / 6, hp = u % 6, c0 = 2 * cp, head = 2 * hp + hs;
                    const int jt0 = (8 - c0) > 0 ? (8 - c0) : 0;
                    const int qrow = 64 * (c0 + cs) + 32 * qb;
                    TileBandP TF{KVQ, c0 - 8, hp};
                    attn_unit<128, true, TileBandP>(lds, tid, TF, jt0, 10, KVQ + (size_t)(qrow + l31) * NKVQ + 1536 + 64 * head, true, cs, cs + 8, 64 * hs, 64,
                                                    64 * (cs + 8) + 32 * qb + l31, rel_bias + (size_t)(2 * hp) * 257, hs, A2 + (size_t)qrow * DM + 64 * head);
                } else {
                    const int us = u - 768, b = us / 6, hp = us % 6, head = 2 * hp + hs;
                    const int qrow = SEQ + 32 * b;
                    TileBandS TF{KVQ, cbk, cbv, b, hp};
                    attn_unit<128, true, TileBandS>(lds, tid, TF, 0, 9, KVQ + (size_t)(qrow + l31) * NKVQ + 1536 + 64 * head, (cs == 0 && qb == 0), 0, 8, 64 * hs, 32,
                                                    512 + l31, rel_bias + (size_t)(2 * hp) * 257, hs, A2 + (size_t)qrow * DM + 64 * head);
                }
              } }
            mem_units(lds, tid, G, bx, 960, 1, WSP(WS_BIG), NKVQ, 2304, WSP(WS_MEMKV), INP(2), INP(3), WSP(WS_A2));
            __syncthreads();
        }
        if (MK_ONE_LAUNCH && ph + 1 < args.ph_hi) { XcdBarrier bar; bar.bar = (unsigned*)(args.ws + WS_CTL) + CW_BAR; bar.x = xb_xcc_id(); bar.st = (volatile LAS unsigned*)(lds + MISC_OFF) + 8; xcd_barrier(bar); }
    }
}

#ifndef MK_DEBUG
#define MK_DEBUG 0
#endif
#if MK_DEBUG
#ifndef DBG_BASE
#define DBG_BASE 0
#endif
constexpr size_t WS_ERR = 32 * 1024;
struct ChkArgs { const float* in[26]; float* out; unsigned char* ws; int stage; int pad; };
__device__ __forceinline__ float bfv(const bf16* p, size_t i) { return __builtin_bit_cast(float, (unsigned)p[i] << 16); }
__device__ __forceinline__ unsigned hsh(unsigned i, unsigned salt) { unsigned h = i * 2654435761u + salt * 40503u; h ^= h >> 15; h *= 2246822519u; h ^= h >> 13; return h; }
__device__ float dbg_gelu(float x) { const float z = 0.7978845608f * (x + 0.044715f * x * x * x); return 0.5f * x * (1.0f + tanhf(z)); }
__device__ float dbg_dot(const bf16* a, const bf16* b, int K) { float s = 0.f; for (int k = 0; k < K; ++k) s += bfv(a, k) * bfv(b, k); return s; }
__device__ int dbg_row(unsigned h, int kind) { return kind ? SEQ + (int)(h % NSAMP) : (int)(h % SEQ); }
__device__ float dbg_v(const bf16* Z, const float* g_ln, const float* b_ln, int row, int c) {
    const int g = c / 192; float s = 0.f; for (int j = 0; j < 192; ++j) s += bfv(Z, (size_t)row * NZ + 768 + g * 192 + j);
    const float mean = s / 192.f; float q = 0.f; for (int j = 0; j < 192; ++j) { const float d = bfv(Z, (size_t)row * NZ + 768 + g * 192 + j) - mean; q += d * d; }
    return (bfv(Z, (size_t)row * NZ + 768 + c) - mean) / sqrtf(q / 192.f + EPS) * g_ln[c] + b_ln[c];
}
__global__ void __launch_bounds__(256) chk_kernel(ChkArgs a) {
    const int gt = blockIdx.x * 256 + threadIdx.x, NT = gridDim.x * 256, st = a.stage;
    unsigned char* ws = a.ws; float* out = a.out;
    const bf16* XN = WSP(WS_XN); const bf16* Y = WSP(WS_Y); const bf16* A2 = WSP(WS_A2); const bf16* Z = WSP(WS_BIG); const bf16* KVQ = WSP(WS_BIG); const bf16* H = WSP(WS_H);
    const bf16* MEMKV = WSP(WS_MEMKV); const bf16* MEMN = WSP(WS_MEMN);
    float num = 0.f, den = 0.f;
#define ACC(av, rv) do { const float a_ = (av), r_ = (rv), d_ = a_ - r_; num += d_ * d_; den += r_ * r_; } while (0)
    const int NS = 4096;
    for (int i = gt; i < NS; i += NT) {
        const unsigned h0 = hsh(i, 1), h1 = hsh(i, 2), h2 = hsh(i, 3);
        if (st == 0) {
            const int row = (i & 1) ? dbg_row(h0, 1) : dbg_row(h0, 0), col = h1 % DM;
            const float* x = row < SEQ ? a.in[0] + (size_t)row * DM : a.in[1] + (size_t)(row - SEQ) * DM;
            float s = 0.f; for (int k = 0; k < DM; ++k) s += x[k] * x[k];
            ACC(bfv(XN, (size_t)row * DM + col), x[col] / sqrtf(s / DM + EPS));
        } else if (st == 1) {
            const int n = h0 % NZ, k = h1 % DM; ACC(bfv(WSP(WS_INA), (size_t)n * DM + k), a.in[13][(size_t)k * NZ + n] * a.in[7][k]);
        } else if (st == 2) {
            const int n = h0 % DM, k = h1 % FF; ACC(bfv(WSP(WS_FF2), (size_t)FF * DM + (size_t)n * FF + k), a.in[25][(size_t)DM * FF + (size_t)k * DM + n]);
            const int n2 = h1 % FF, k2 = h0 % DM; ACC(bfv(WSP(WS_FF1), (size_t)FF * DM + (size_t)n2 * DM + k2), a.in[24][(size_t)DM * FF + (size_t)k2 * FF + n2] * a.in[9][DM + k2]);
        } else if (st == 3) {
            const int n = h0 % NKVQ, k = h1 % DM;
            const float r = n < 1536 ? a.in[20][(size_t)k * 1536 + n] * a.in[19][k] : a.in[21][(size_t)k * DM + (n - 1536)] * a.in[7][DM + k];
            ACC(bfv(WSP(WS_KVINB), (size_t)n * DM + k), r);
            const int n2 = h2 % DM; ACC(bfv(WSP(WS_OUTA), (size_t)n2 * DM + k), a.in[18][(size_t)k * DM + n2]); ACC(bfv(WSP(WS_OUTB), (size_t)n2 * DM + k), a.in[23][(size_t)k * DM + n2]);
        } else if (st == 4) {
            const int n = h0 % 1024, k = h1 % DM, l = n >> 9;
            ACC(bfv(WSP(WS_WMEM), (size_t)n * DM + k), a.in[12][(size_t)l * DM * 512 + (size_t)k * 512 + (n & 511)] * a.in[11][l * DM + k]);
            const int e = h2 % 65536, sI = e & 127, tI = (e >> 7) & 127; ACC(bfv(WSP(WS_WSB), e), sI <= tI ? a.in[16][e] : 0.f);
        } else if (st == 5) {
            const int row = (i & 1) ? dbg_row(h0, 1) : dbg_row(h0, 0), col = h1 % NZ;
            float r = dbg_dot(XN + (size_t)row * DM, WSP(WS_INA) + (size_t)col * DM, DM); if (col < 1536) r = dbg_gelu(r);
            ACC(bfv(Z, (size_t)row * NZ + col), r);
        } else if (st == 6) {
            const int m = h0 % 256, n = h1 % 1024, l = n >> 9, isv = (n >> 8) & 1, c = n & 255;
            const float r = dbg_dot(MEMN + (size_t)m * DM, WSP(WS_WMEM) + (size_t)n * DM, DM);
            ACC(out[(isv ? pg8::OUT_MV : pg8::OUT_MK) + (size_t)(l * 256 + m) * 256 + c], r); ACC(bfv(MEMKV, (size_t)(l * 256 + m) * 512 + isv * 256 + c), r);
        } else if (st == 7) {
            const int row = dbg_row(h0, 1), c = h1 % 768;
            ACC(out[pg8::OUT_GV + (size_t)(row - SEQ) * 768 + c], dbg_v(Z, a.in[14], a.in[15], row, c));
        } else if (st == 8 || st == 9) {
            if (i < 1024) { const int row = dbg_row(h0, st - 8), c = h1 % 768, g = c / 192;
            const int cb = row < SEQ ? (row & ~127) : (row & ~31), t = row - cb;
            float mx = a.in[17][g * 128 + t];
            for (int sI = 0; sI <= t; ++sI) mx += a.in[16][(size_t)g * 16384 + t * 128 + sI] * dbg_v(Z, a.in[14], a.in[15], cb + sI, c);
            ACC(bfv(A2, (size_t)row * DM + c), bfv(Z, (size_t)row * NZ + c) * mx); }
        } else if (st == 10 || st == 11 || st == 20 || st == 21) {
            const int layer = st >= 20, kind = st & 1; const int row = dbg_row(h0, kind), hd = h1 % 4, d = h2 % 64;
            const bf16* Q = layer ? KVQ + (size_t)row * NKVQ + 2304 + 64 * hd : Z + (size_t)row * NZ + 1536 + 64 * hd;
            float mxs = -INFINITY, l = 0.f, o = 0.f;
            for (int pass = 0; pass < 2; ++pass)
            for (int key = 0; key < 256; ++key) { float dsum = 0.f;
                for (int e = 0; e < 64; ++e) { const float kv = kind ? a.in[2][(((size_t)(layer * 32 + (row - SEQ) / 32) * 256 + key) * 4 + hd) * 64 + e] : bfv(MEMKV, (size_t)(layer * 256 + key) * 512 + 64 * hd + e); dsum += bfv(Q, e) * kv; }
                const float scv = dsum * 0.125f;
                if (pass == 0) mxs = fmaxf(mxs, scv);
                else { const float p = expf(scv - mxs); l += p;
                    const float vv = kind ? a.in[3][(((size_t)(layer * 32 + (row - SEQ) / 32) * 256 + key) * 4 + hd) * 64 + d] : bfv(MEMKV, (size_t)(layer * 256 + key) * 512 + 256 + 64 * hd + d); o += p * vv; } }
            ACC(bfv(A2, (size_t)row * DM + 768 + 64 * hd + d), o / l);
        } else if (st == 12 || st == 22 || st == 25) {
            const int row = (i & 1) ? dbg_row(h0, 1) : dbg_row(h0, 0), col = h1 % DM;
            if (st == 25) ACC(bfv(Y, (size_t)row * DM + col), dbg_dot(H + (size_t)row * FF, WSP(WS_FF2) + (size_t)FF * DM + (size_t)col * FF, FF));
            else ACC(bfv(Y, (size_t)row * DM + col), dbg_dot(A2 + (size_t)row * DM, (st == 12 ? WSP(WS_OUTA) : WSP(WS_OUTB)) + (size_t)col * DM, DM));
        } else if (st == 13) {
            const int row = (i & 1) ? dbg_row(h0, 1) : dbg_row(h0, 0), col = h1 % DM;
            const float* x = row < SEQ ? a.in[0] + (size_t)row * DM : a.in[1] + (size_t)(row - SEQ) * DM;
            float s = 0.f; for (int k = 0; k < DM; ++k) { const float y = bfv(Y, (size_t)row * DM + k); s += y * y; }
            const float ry = 1.0f / sqrtf(s / DM + EPS); float s1 = 0.f;
            for (int k = 0; k < DM; ++k) { const float v = x[k] + bfv(Y, (size_t)row * DM + k) * ry * a.in[8][k]; s1 += v * v; }
            const float x1 = x[col] + bfv(Y, (size_t)row * DM + col) * ry * a.in[8][col];
            ACC(out[(size_t)row * DM + col], x1); ACC(bfv(XN, (size_t)row * DM + col), x1 / sqrtf(s1 / DM + EPS));
        } else if (st == 14 || st == 24) {
            const int row = (i & 1) ? dbg_row(h0, 1) : dbg_row(h0, 0), col = h1 % FF;
            float r = dbg_dot(XN + (size_t)row * DM, WSP(WS_FF1) + (st == 24 ? (size_t)FF * DM : 0) + (size_t)col * DM, DM); r = r > 0.f ? r * r : 0.f;
            ACC(bfv(H, (size_t)row * FF + col), r);
        } else if (st == 15) {
            const int row = (i & 1) ? dbg_row(h0, 1) : dbg_row(h0, 0), col = h1 % DM;
            ACC(bfv(Y, (size_t)row * DM + col), dbg_dot(H + (size_t)row * FF, WSP(WS_FF2) + (size_t)col * FF, FF));
        } else if (st == 16 || st == 23) {
            const int row = (i & 1) ? dbg_row(h0, 1) : dbg_row(h0, 0), col = h1 % DM;
            float s = 0.f; for (int k = 0; k < DM; ++k) { const float v = out[(size_t)row * DM + k]; s += v * v; }
            ACC(bfv(XN, (size_t)row * DM + col), out[(size_t)row * DM + col] / sqrtf(s / DM + EPS));
        } else if (st == 17) {
            const int col = h1 % NKVQ; int row = (i & 1) ? dbg_row(h0, 1) : dbg_row(h0, 0); if ((i & 3) == 2) row = 15872 + (int)(h0 % 512);
            const float r = dbg_dot(XN + (size_t)row * DM, WSP(WS_KVINB) + (size_t)col * DM, DM);
            ACC(bfv(KVQ, (size_t)row * NKVQ + col), r);
            if (col < 1536 && row >= 15872) { const int isv = col >= 768, c = col - (isv ? 768 : 0);
                const float o = row >= SEQ ? out[(isv ? pg8::OUT_BVS : pg8::OUT_BKS) + (size_t)(row - SEQ) * 768 + c] : out[(isv ? pg8::OUT_BVP : pg8::OUT_BKP) + (size_t)(row - 15872) * 768 + c];
                ACC(o, r); }
        } else if (st == 18 || st == 19) {
            if (i < 1024) { const int kind = st - 18; int row = dbg_row(h0, kind); if (kind == 0 && (i & 7) == 0) row = (int)(h0 % 640); const int hd = h1 % 12, d = h2 % 64;
            const bf16* Q = KVQ + (size_t)row * NKVQ + 1536 + 64 * hd; const float* rb = a.in[22] + hd * 257;
            const int nk = kind ? 544 : 576; const int t = kind ? (row - SEQ) % 32 : row % 64; const int c = row / 64, b = (row - SEQ) / 32;
            float mxs = -INFINITY;
            for (int pass = 0; pass < 2; ++pass) { float l = 0.f, o = 0.f;
                for (int j = 0; j < nk; ++j) {
                    const int pos = 64 * c - 512 + j; if (!kind && pos < 0) continue;
                    float dsum = 0.f, vv;
                    if (kind && j < 512) { const float* kp = a.in[4] + (((size_t)b * 512 + j) * 12 + hd) * 64; for (int e = 0; e < 64; ++e) dsum += bfv(Q, e) * kp[e]; vv = a.in[5][(((size_t)b * 512 + j) * 12 + hd) * 64 + d]; }
                    else { const size_t kr = kind ? (size_t)(SEQ + 32 * b + j - 512) : (size_t)pos; for (int e = 0; e < 64; ++e) dsum += bfv(Q, e) * bfv(KVQ, kr * NKVQ + 64 * hd + e); vv = bfv(KVQ, kr * NKVQ + 768 + 64 * hd + d); }
                    int rel = 512 + t - j; rel = rel < -128 ? -128 : (rel > 128 ? 128 : rel);
                    const float sc = dsum * 0.125f + rb[rel + 128];
                    if (pass == 0) mxs = fmaxf(mxs, sc); else { const float p = expf(sc - mxs); l += p; o += p * vv; } }
                if (pass == 1) ACC(bfv(A2, (size_t)row * DM + 64 * hd + d), o / l); } }
        }
    }
#undef ACC
    for (int o = 32; o > 0; o >>= 1) { num += __shfl_xor(num, o); den += __shfl_xor(den, o); }
    if ((threadIdx.x & 63) == 0) { float* err = (float*)(ws + WS_ERR); atomicAdd(err + 2 * st, num); atomicAdd(err + 2 * st + 1, den); }
}
__global__ void __launch_bounds__(256) report_kernel(float* out, unsigned char* ws, int nstage) {
    const float* err = (const float*)(ws + WS_ERR);
    float V = 1e30f;
    for (int s = DBG_BASE; s < nstage; ++s) { const float n = err[2 * s], d = err[2 * s + 1]; if (d == 0.f && n == 0.f) continue; const float rel = sqrtf(n / fmaxf(d, 1e-30f));
        if (!(rel < 0.03f)) { float E = rel * 10.f; E = E < 1.f ? 1.f : (E > 99.f ? 99.f : E); if (!(rel == rel)) E = 50.f; V = E; for (int k = DBG_BASE; k < s; ++k) V *= 100.f; break; } }
    for (size_t i = (size_t)blockIdx.x * 256 + threadIdx.x; i < pg8::OUT_END; i += (size_t)gridDim.x * 256) out[i] = V;
}
#endif

extern "C" void kernel_launch(void* const* d_in, const int* in_sizes, int n_in, void* d_out, int out_size, void* d_ws, size_t ws_size, hipStream_t stream) {
    static int grid = 0;
    if (grid == 0) {
        if (n_in != 26 || (size_t)out_size != pg8::OUT_END || ws_size < WS_END) { fprintf(stderr, "kernel_launch: unexpected shapes (n_in %d out %d ws %zu)\n", n_in, out_size, ws_size); grid = -1; return; }
        int dev = 0, cus = 0;
        if (hipGetDevice(&dev) != hipSuccess || hipDeviceGetAttribute(&cus, hipDeviceAttributeMultiprocessorCount, dev) != hipSuccess) { grid = -1; return; }
        if (hipFuncSetAttribute((const void*)mk_fwd, hipFuncAttributeMaxDynamicSharedMemorySize, LDS_BYTES) != hipSuccess) { fprintf(stderr, "kernel_launch: hipFuncSetAttribute failed\n"); grid = -1; return; }
        int per_cu = 0;
        if (hipOccupancyMaxActiveBlocksPerMultiprocessor(&per_cu, (const void*)mk_fwd, NWAVES * 64, LDS_BYTES) != hipSuccess || per_cu < 1) fprintf(stderr, "kernel_launch: occupancy query reports %d\n", per_cu);
        (void)hipGetLastError();
        grid = cus < 256 ? cus : 256;
    }
    if (grid < 0) return;
    if (hipMemsetAsync((char*)d_ws + WS_CTL, 0, CTL_ZERO_BYTES, stream) != hipSuccess) return;
    Args a{};
    for (int i = 0; i < 26; ++i) a.in[i] = (const float*)d_in[i];
    a.out = (float*)d_out; a.ws = (unsigned char*)d_ws;
#if MK_ONE_LAUNCH
    a.ph_lo = 0; a.ph_hi = NPHASE;
    hipLaunchKernelGGL(mk_fwd, dim3(grid), dim3(NWAVES * 64), LDS_BYTES, stream, a);
#else
    for (int ph = 0; ph < NPHASE; ++ph) { a.ph_lo = ph; a.ph_hi = ph + 1; hipLaunchKernelGGL(mk_fwd, dim3(grid), dim3(NWAVES * 64), LDS_BYTES, stream, a);
#if MK_DEBUG
        static const int chk_tab[NPHASE][6] = { {0, 1, 2, 3, 4, -1}, {5, 6, -1}, {7, 8, 9, 10, 11, -1}, {12, -1}, {13, -1}, {14, -1}, {15, -1}, {16, -1}, {17, -1}, {18, 19, 20, 21, -1}, {22, -1}, {23, -1}, {24, -1}, {25, -1}, {-1} };
        for (int j = 0; j < 6 && chk_tab[ph][j] >= 0; ++j) { ChkArgs c{}; for (int i = 0; i < 26; ++i) c.in[i] = (const float*)d_in[i]; c.out = (float*)d_out; c.ws = (unsigned char*)d_ws; c.stage = chk_tab[ph][j];
            hipLaunchKernelGGL(chk_kernel, dim3(64), dim3(256), 0, stream, c); }
#endif
    }
#if MK_DEBUG
    hipLaunchKernelGGL(report_kernel, dim3(256), dim3(256), 0, stream, (float*)d_out, (unsigned char*)d_ws, 26);
#endif
#endif
}
```
